# Optimizing an MI355X kernel written in HIP

```python
import math
import jax
import jax.numpy as jnp
from jax import lax
import numpy as np

D_MODEL = 1024
BATCH = 16
SEQ = 2048
DEPTH = 2

HEAD_DIM = 64
MIX_WIDTH = D_MODEL
N_HEADS_A = (MIX_WIDTH // 2) // (2 * HEAD_DIM)
DV_A = 2 * HEAD_DIM
N_HEADS_B = (MIX_WIDTH // 2) // HEAD_DIM
DILATED_PATTERNS = ((128, 1), (512, 4), (2048, 16))
N_HEADS_C = (MIX_WIDTH // 2) // HEAD_DIM
MOBA_BLOCK = 256
MOBA_TOPK = 3
MOBA_Q_CHUNK = 16
N_HEADS_D = (MIX_WIDTH // 2) // HEAD_DIM
FORGET_BIAS_INIT = 4.0
Q_BLOCK = 128
NUM_BUCKETS = 32
MAX_DISTANCE = 128
N_BIAS_HEADS = max(N_HEADS_A + N_HEADS_B, N_HEADS_C)
D_FF = -(-8 * D_MODEL // (3 * 256)) * 256
LN_EPS = 1e-5
DEEPNORM_ALPHA = (2 * DEPTH) ** 0.25
DEEPNORM_BETA = (8 * DEPTH) ** -0.25
ATTN_SCALE = HEAD_DIM ** -0.5

AB_SIZES = [N_HEADS_A * 2 * HEAD_DIM, N_HEADS_A * 2 * HEAD_DIM, N_HEADS_A * DV_A,
            N_HEADS_B * HEAD_DIM, N_HEADS_B * HEAD_DIM, N_HEADS_B * HEAD_DIM]
CD_SIZES = [N_HEADS_C * HEAD_DIM] * 3 + [N_HEADS_D * HEAD_DIM] * 3 + [N_HEADS_D]
AB_SPLITS = [int(s) for s in np.cumsum(AB_SIZES)[:-1]]
CD_SPLITS = [int(s) for s in np.cumsum(CD_SIZES)[:-1]]
IN_AB = sum(AB_SIZES)
IN_CD = sum(CD_SIZES)

kernel_name = "hybrid_diff_dilated_moba_fox_block"

f32 = jnp.float32


def t5_bucket(dist):
    n = jnp.maximum(dist, 0)
    max_exact = NUM_BUCKETS // 2
    nf = jnp.maximum(n, 1).astype(f32)
    large = max_exact + (jnp.log(nf / max_exact) / math.log(MAX_DISTANCE / max_exact)
                         * (NUM_BUCKETS - max_exact)).astype(jnp.int32)
    large = jnp.minimum(large, NUM_BUCKETS - 1)
    return jnp.where(n < max_exact, n, large)


def t5_bias(table_cols, dist):
    return jnp.moveaxis(table_cols[t5_bucket(dist)], -1, 0).astype(f32)


def layer_norm(x, g, b):
    xf = x.astype(f32)
    mu = xf.mean(-1, keepdims=True)
    var = jnp.square(xf - mu).mean(-1, keepdims=True)
    return ((xf - mu) * lax.rsqrt(var + LN_EPS) * g + b).astype(x.dtype)


def causal_block_attention(q, k, v, map_w, bias_fn):
    B, H, M, T, _ = q.shape
    k_pos = jnp.arange(T)

    def block(q0):
        qb = lax.dynamic_slice_in_dim(q, q0, Q_BLOCK, axis=3)
        q_pos = q0 + jnp.arange(Q_BLOCK)
        s = jnp.einsum('bhmqd,bhmkd->bhmqk', qb, k).astype(f32) + bias_fn(q_pos)
        s = jnp.where(k_pos[None, :] <= q_pos[:, None], s, -jnp.inf)
        p = jnp.einsum('bhmqk,m->bhqk', jax.nn.softmax(s, axis=-1), map_w)
        return jnp.einsum('bhqk,bhkd->bhqd', p.astype(v.dtype), v)

    out = lax.map(block, jnp.arange(T // Q_BLOCK) * Q_BLOCK)
    return jnp.moveaxis(out, 0, 2).reshape(B, H, T, v.shape[-1])


def dilated_attention(q, k, v, table_cols):
    B, H, T, dh = q.shape
    outs, lses = [], []
    for window, dil in DILATED_PATTERNS:
        W = window // dil
        L = T // dil
        nb = -(-L // W)
        pad = nb * W - L

        def strided(a):
            a = a.reshape(B, H, L, dil, a.shape[-1]).swapaxes(2, 3)
            return jnp.pad(a, ((0, 0), (0, 0), (0, 0), (0, pad), (0, 0)))

        def with_prev(a):
            ab = a.reshape(B, H, dil, nb, W, a.shape[-1])
            prev = jnp.pad(ab, ((0, 0), (0, 0), (0, 0), (1, 0), (0, 0), (0, 0)))[:, :, :, :-1]
            return jnp.concatenate([prev, ab], axis=4)

        qb = strided(q).reshape(B, H, dil, nb, W, dh)
        kb = with_prev(strided(k))
        vb = with_prev(strided(v))
        u_q = jnp.arange(nb)[:, None] * W + jnp.arange(W)[None, :]
        u_k = jnp.arange(nb)[:, None] * W + jnp.arange(-W, W)[None, :]
        du = u_q[:, :, None] - u_k[:, None, :]
        valid = (du >= 0) & (du <= W) & (u_k[:, None, :] >= 0)
        bias = t5_bias(table_cols, du * dil)
        s = jnp.einsum('bhrnqd,bhrnkd->bhrnqk', qb, kb).astype(f32) + bias[None, :, None]
        s = jnp.where(valid, s, -jnp.inf)
        m = s.max(-1, keepdims=True)
        p = jnp.exp(s - m)
        den = p.sum(-1)
        o = jnp.einsum('bhrnqk,bhrnkd->bhrnqd', p.astype(vb.dtype), vb) / den[..., None]
        o = o.reshape(B, H, dil, nb * W, dh)[:, :, :, :L].swapaxes(2, 3).reshape(B, H, T, dh)
        lse = (m[..., 0] + jnp.log(den)).reshape(B, H, dil, nb * W)[..., :L]
        outs.append(o)
        lses.append(lse.swapaxes(2, 3).reshape(B, H, T))
    w = jax.nn.softmax(jnp.stack(lses), axis=0)
    return jnp.sum(w[..., None] * jnp.stack(outs), axis=0).astype(q.dtype)


def moba_attention(q, k, v, table_cols):
    B, H, T, dh = q.shape
    n_blk = -(-T // MOBA_BLOCK)
    pad = n_blk * MOBA_BLOCK - T
    kp = jnp.pad(k, ((0, 0), (0, 0), (0, pad), (0, 0)))
    vp = jnp.pad(v, ((0, 0), (0, 0), (0, pad), (0, 0)))
    k_blk = kp.reshape(B, H, n_blk, MOBA_BLOCK, dh)
    v_blk = vp.reshape(B, H, n_blk, MOBA_BLOCK, dh)
    k_mean = k_blk.mean(axis=3)
    top = min(MOBA_TOPK, n_blk)
    b_idx = jnp.arange(B)[:, None, None, None]
    h_idx = jnp.arange(H)[None, :, None, None]
    bias_flat = table_cols.T.reshape(-1).astype(f32)
    in_blk = jnp.arange(MOBA_BLOCK)

    def chunk(q0):
        qc = lax.dynamic_slice_in_dim(q, q0, MOBA_Q_CHUNK, axis=2)
        q_pos = q0 + jnp.arange(MOBA_Q_CHUNK)
        own = q0 // MOBA_BLOCK
        gate = jnp.einsum('bhcd,bhnd->bhcn', qc, k_mean).astype(f32)
        gate = jnp.where(jnp.arange(n_blk) < own, gate, -jnp.inf)
        top_s, top_i = lax.top_k(gate, top)
        sel_ok = jnp.isfinite(top_s)
        k_sel = k_blk[b_idx, h_idx, top_i]
        v_sel = v_blk[b_idx, h_idx, top_i]
        sel_pos = top_i[..., None] * MOBA_BLOCK + in_blk
        sel_bucket = t5_bucket(q_pos[:, None, None] - sel_pos)
        s_sel = (jnp.einsum('bhcd,bhcnkd->bhcnk', qc, k_sel).astype(f32)
                 + bias_flat[h_idx[..., None] * NUM_BUCKETS + sel_bucket])
        s_sel = jnp.where(sel_ok[..., None], s_sel, -jnp.inf)
        own_start = own * MOBA_BLOCK
        k_own = lax.dynamic_slice_in_dim(kp, own_start, MOBA_BLOCK, axis=2)
        v_own = lax.dynamic_slice_in_dim(vp, own_start, MOBA_BLOCK, axis=2)
        own_dist = q_pos[:, None] - (own_start + in_blk)[None, :]
        s_own = (jnp.einsum('bhcd,bhkd->bhck', qc, k_own).astype(f32)
                 + t5_bias(table_cols, own_dist)[None])
        s_own = jnp.where(own_dist >= 0, s_own, -jnp.inf)
        s = jnp.concatenate([s_sel.reshape(B, H, MOBA_Q_CHUNK, top * MOBA_BLOCK), s_own], axis=-1)
        p = jax.nn.softmax(s, axis=-1).astype(v.dtype)
        p_sel = p[..., :top * MOBA_BLOCK].reshape(B, H, MOBA_Q_CHUNK, top, MOBA_BLOCK)
        p_own = p[..., top * MOBA_BLOCK:]
        return (jnp.einsum('bhcnk,bhcnkd->bhcd', p_sel, v_sel)
                + jnp.einsum('bhck,bhkd->bhcd', p_own, v_own))

    out = lax.map(chunk, jnp.arange(T // MOBA_Q_CHUNK) * MOBA_Q_CHUNK)
    return jnp.moveaxis(out, 0, 2).reshape(B, H, T, dh)


def split_heads(a, dh):
    B, T, _ = a.shape
    return a.reshape(B, T, -1, dh).transpose(0, 2, 1, 3)


def merge_heads(a):
    B, H, T, dh = a.shape
    return a.transpose(0, 2, 1, 3).reshape(B, T, H * dh)


def mixer_ab(h, w_in, w_o, lam, subln_g, table, lambda_init):
    B, T, _ = h.shape
    qa, ka, va, qb, kb, vb = jnp.split(h @ w_in, AB_SPLITS, axis=-1)
    qa = qa.reshape(B, T, N_HEADS_A, 2, HEAD_DIM).transpose(0, 2, 3, 1, 4) * ATTN_SCALE
    ka = ka.reshape(B, T, N_HEADS_A, 2, HEAD_DIM).transpose(0, 2, 3, 1, 4)
    va = split_heads(va, DV_A)
    lamf = lam.astype(f32)
    lam_full = (jnp.exp(jnp.sum(lamf[0] * lamf[1])) - jnp.exp(jnp.sum(lamf[2] * lamf[3]))
                + lambda_init)
    map_w = jnp.stack([jnp.ones((), f32), -lam_full])
    table_a = table[:, :N_HEADS_A]
    k_pos = jnp.arange(T)
    bias_a = lambda q_pos: t5_bias(table_a, q_pos[:, None] - k_pos[None, :])[None, :, None]
    oa = causal_block_attention(qa, ka, va, map_w, bias_a).astype(f32)
    oa = oa * lax.rsqrt(jnp.mean(jnp.square(oa), -1, keepdims=True) + LN_EPS)
    oa = (oa * subln_g * (1.0 - lambda_init)).astype(h.dtype)
    ob = dilated_attention(split_heads(qb, HEAD_DIM) * ATTN_SCALE, split_heads(kb, HEAD_DIM),
                           split_heads(vb, HEAD_DIM), table[:, N_HEADS_A:N_HEADS_A + N_HEADS_B])
    return jnp.concatenate([merge_heads(oa), merge_heads(ob)], axis=-1) @ w_o


def mixer_cd(h, w_in, w_o, forget_b, table):
    qc, kc, vc, qd, kd, vd, fd = jnp.split(h @ w_in, CD_SPLITS, axis=-1)
    oc = moba_attention(split_heads(qc, HEAD_DIM) * ATTN_SCALE, split_heads(kc, HEAD_DIM),
                        split_heads(vc, HEAD_DIM), table[:, :N_HEADS_C])
    log_f = jax.nn.log_sigmoid((fd + forget_b).astype(f32)).transpose(0, 2, 1)
    cum = jnp.cumsum(log_f, axis=-1)
    fox_bias = lambda q_pos: (cum[:, :, q_pos, None] - cum[:, :, None, :])[:, :, None]
    od = causal_block_attention((split_heads(qd, HEAD_DIM) * ATTN_SCALE)[:, :, None],
                                split_heads(kd, HEAD_DIM)[:, :, None],
                                split_heads(vd, HEAD_DIM), jnp.ones((1,), f32), fox_bias)
    return jnp.concatenate([merge_heads(oc), merge_heads(od)], axis=-1) @ w_o


def swiglu(h, w_in, w_out):
    g, u = jnp.split(h @ w_in, 2, axis=-1)
    return (jax.nn.silu(g) * u) @ w_out


def setup_inputs(seed: int = 0) -> dict:
    key = jax.random.key(seed)
    ks = jax.random.split(key, 15)
    n_even = (DEPTH + 1) // 2
    n_odd = DEPTH // 2
    nrm = lambda k, shape, std: jax.random.normal(k, shape, f32) * std
    return {
        "x": nrm(ks[0], (BATCH, SEQ, D_MODEL), 1.0),
        "c": nrm(ks[1], (BATCH, D_MODEL), 1.0),
        "rel_bias": nrm(ks[2], (NUM_BUCKETS, N_BIAS_HEADS), 0.5),
        "w_ada": nrm(ks[3], (DEPTH, D_MODEL, 6 * D_MODEL), 0.1 * D_MODEL ** -0.5),
        "b_ada": nrm(ks[4], (DEPTH, 6 * D_MODEL), 0.01),
        "ln_g": 1.0 + nrm(ks[5], (DEPTH, 2, D_MODEL), 0.01),
        "ln_b": nrm(ks[6], (DEPTH, 2, D_MODEL), 0.01),
        "w_in_ab": nrm(ks[7], (n_even, D_MODEL, IN_AB), D_MODEL ** -0.5),
        "diff_lambda": nrm(ks[8], (n_even, 4, HEAD_DIM), 0.1),
        "diff_subln_g": 1.0 + nrm(ks[9], (n_even, DV_A), 0.01),
        "w_in_cd": nrm(ks[10], (n_odd, D_MODEL, IN_CD), D_MODEL ** -0.5),
        "forget_b": FORGET_BIAS_INIT + nrm(ks[11], (n_odd, N_HEADS_D), 0.5),
        "w_o": nrm(ks[12], (DEPTH, MIX_WIDTH, D_MODEL), DEEPNORM_BETA * MIX_WIDTH ** -0.5),
        "w_ffn_in": nrm(ks[13], (DEPTH, D_MODEL, 2 * D_FF), D_MODEL ** -0.5),
        "w_ffn_out": nrm(ks[14], (DEPTH, D_FF, D_MODEL), DEEPNORM_BETA * D_FF ** -0.5),
    }


def reference(x, c, rel_bias, w_ada, b_ada, ln_g, ln_b, w_in_ab, diff_lambda, diff_subln_g,
              w_in_cd, forget_b, w_o, w_ffn_in, w_ffn_out):
    for l in range(DEPTH):
        ada = jax.nn.silu(c) @ w_ada[l] + b_ada[l]
        sh1, sc1, g1, sh2, sc2, g2 = [a[:, None, :] for a in jnp.split(ada, 6, axis=-1)]
        h = x * (1.0 + sc1) + sh1
        if l % 2 == 0:
            i = l // 2
            lambda_init = 0.8 - 0.6 * math.exp(-0.3 * l)
            y = mixer_ab(h, w_in_ab[i], w_o[l], diff_lambda[i], diff_subln_g[i], rel_bias,
                         lambda_init)
        else:
            i = l // 2
            y = mixer_cd(h, w_in_cd[i], w_o[l], forget_b[i], rel_bias)
        x = layer_norm(DEEPNORM_ALPHA * x + (1.0 + g1) * y, ln_g[l, 0], ln_b[l, 0])
        h = x * (1.0 + sc2) + sh2
        y = swiglu(h, w_ffn_in[l], w_ffn_out[l])
        x = layer_norm(DEEPNORM_ALPHA * x + (1.0 + g2) * y, ln_g[l, 1], ln_b[l, 1])
    return x
```

```cpp
#include <hip/hip_runtime.h>
#include <cstdint>
#include <cstdio>

constexpr int BATCH = 16, SEQ = 2048, DM = 1024, MTOK = BATCH * SEQ;
constexpr int IN_AB = 3072, IN_CD = 3080, DFF = 2816;
constexpr float LN_EPS = 1e-5f, ALPHA = 1.41421356237309515f, ASCALE = 0.125f;
constexpr int CH_B = 2, CH_T = CH_B * SEQ, NCH = BATCH / CH_B;

__device__ __forceinline__ int t5_bucket(int d) {
    if (d < 16) return d;
    return 16 + (d >= 19) + (d >= 21) + (d >= 24) + (d >= 27) + (d >= 31) + (d >= 35) + (d >= 40) + (d >= 46) + (d >= 52) + (d >= 59) +
           (d >= 67) + (d >= 77) + (d >= 87) + (d >= 99) + (d >= 113);
}

__global__ void __launch_bounds__(256) ada_kernel(const float* __restrict__ c, const float* __restrict__ w_ada, const float* __restrict__ b_ada, float* __restrict__ ada) {
    __shared__ float sc[16][64];
    const int l = blockIdx.y, j = blockIdx.x * 256 + threadIdx.x;
    float acc[16];
#pragma unroll
    for (int b = 0; b < 16; ++b) acc[b] = 0.f;
    for (int k0 = 0; k0 < DM; k0 += 64) {
        __syncthreads();
        for (int i = threadIdx.x; i < 16 * 64; i += 256) { const int b = i >> 6, k = i & 63; const float v = c[b * DM + k0 + k]; sc[b][k] = v / (1.f + expf(-v)); }
        __syncthreads();
        for (int k = 0; k < 64; ++k) {
            const float w = w_ada[((size_t)l * DM + k0 + k) * (6 * DM) + j];
#pragma unroll
            for (int b = 0; b < 16; ++b) acc[b] += sc[b][k] * w;
        }
    }
#pragma unroll
    for (int b = 0; b < 16; ++b) ada[((size_t)l * 16 + b) * (6 * DM) + j] = acc[b] + b_ada[l * 6 * DM + j];
}

__global__ void __launch_bounds__(256) mod_kernel(const float* __restrict__ x, const float* __restrict__ ada_l, int off_sh, int off_sc, float* __restrict__ h, int row0) {
    const size_t i = (size_t)blockIdx.x * 256 + threadIdx.x;
    const int lrow = (int)(i >> 8), c4 = (int)(i & 255);
    const int row = row0 + lrow, b = row / SEQ;
    const float4 xv = ((const float4*)x)[(size_t)row * 256 + c4];
    const float4 sc = *(const float4*)(ada_l + (size_t)b * 6 * DM + off_sc + c4 * 4);
    const float4 sh = *(const float4*)(ada_l + (size_t)b * 6 * DM + off_sh + c4 * 4);
    float4 o; o.x = xv.x * (1.f + sc.x) + sh.x; o.y = xv.y * (1.f + sc.y) + sh.y; o.z = xv.z * (1.f + sc.z) + sh.z; o.w = xv.w * (1.f + sc.w) + sh.w;
    ((float4*)h)[(size_t)lrow * 256 + c4] = o;
}

__global__ void __launch_bounds__(256) gemm_f32(const float* __restrict__ A, int lda, const float* __restrict__ Bw, int ldb, float* __restrict__ C, int ldc, int Mr, int N, int K) {
    __shared__ float As[16][68];
    __shared__ float Bs[16][68];
    const int tid = threadIdx.x, tx = tid & 15, ty = tid >> 4;
    const int m0 = blockIdx.y * 64, n0 = blockIdx.x * 64;
    float acc[4][4];
#pragma unroll
    for (int i = 0; i < 4; ++i)
#pragma unroll
        for (int j = 0; j < 4; ++j) acc[i][j] = 0.f;
    const int ar = tid >> 2, ak = (tid & 3) * 4;
    const int bk = tid >> 4, bc = (tid & 15) * 4;
    for (int k0 = 0; k0 < K; k0 += 16) {
        const float4 av = *(const float4*)(A + (size_t)(m0 + ar) * lda + k0 + ak);
        float4 bv = make_float4(0.f, 0.f, 0.f, 0.f);
        if (n0 + bc < N) bv = *(const float4*)(Bw + (size_t)(k0 + bk) * ldb + n0 + bc);
        __syncthreads();
        As[ak + 0][ar] = av.x; As[ak + 1][ar] = av.y; As[ak + 2][ar] = av.z; As[ak + 3][ar] = av.w;
        *(float4*)&Bs[bk][bc] = bv;
        __syncthreads();
#pragma unroll
        for (int k = 0; k < 16; ++k) {
            const float4 a4 = *(const float4*)&As[k][ty * 4];
            const float4 b4 = *(const float4*)&Bs[k][tx * 4];
            const float a[4] = {a4.x, a4.y, a4.z, a4.w}, b[4] = {b4.x, b4.y, b4.z, b4.w};
#pragma unroll
            for (int i = 0; i < 4; ++i)
#pragma unroll
                for (int j = 0; j < 4; ++j) acc[i][j] += a[i] * b[j];
        }
    }
    if (n0 + tx * 4 < N) {
#pragma unroll
        for (int i = 0; i < 4; ++i) *(float4*)(C + (size_t)(m0 + ty * 4 + i) * ldc + n0 + tx * 4) = make_float4(acc[i][0], acc[i][1], acc[i][2], acc[i][3]);
    }
}

__device__ __forceinline__ float red4(float v) { v += __shfl_xor(v, 1); v += __shfl_xor(v, 2); return v; }

template <int DVP>
__device__ __forceinline__ void osm_update(float s, const float* vrow, float& m, float& l, float (&o)[DVP]) {
    if (s > m) { const float sc = expf(m - s); l *= sc;
#pragma unroll
        for (int i = 0; i < DVP; ++i) o[i] *= sc;
        m = s; }
    const float p = expf(s - m); l += p;
#pragma unroll
    for (int i = 0; i < DVP; ++i) o[i] += p * vrow[i];
}

template <int MODE, int DV>
__global__ void __launch_bounds__(256) attn_dense_kernel(const float* __restrict__ proj, int ld, const float* __restrict__ rel_bias,
                                                         const float* __restrict__ aux0, const float* __restrict__ aux1, float* __restrict__ out) {
    constexpr int DVP = DV / 4;
    __shared__ float Ks[64][68];
    __shared__ float Vs[64][DV + 4];
    __shared__ float biasd[128];
    const int qt = blockIdx.x, h = blockIdx.y, b = blockIdx.z;
    const int tid = threadIdx.x, r = tid >> 2, p = tid & 3;
    const int t = qt * 64 + r;
    const size_t rowb = (size_t)b * SEQ;
    if (tid < 128) biasd[tid] = (MODE == 2) ? 0.f : rel_bias[t5_bucket(tid) * 12 + h];
    int qcol, kcol, vcol, ocol;
    if (MODE == 0) { qcol = h * 128; kcol = 512 + h * 128; vcol = 1024 + h * 128; ocol = h * 128; }
    else if (MODE == 1) { qcol = h * 64; kcol = 512 + h * 64; vcol = 1024 + h * 64; ocol = h * 64; }
    else { qcol = 1536 + h * 64; kcol = 2048 + h * 64; vcol = 2560 + h * 64; ocol = 512 + h * 64; }
    float res[DVP];
#pragma unroll
    for (int i = 0; i < DVP; ++i) res[i] = 0.f;
    float lam = 0.f;
    if (MODE == 0) { float s01 = 0.f, s23 = 0.f; for (int i = 0; i < 64; ++i) { s01 += aux0[i] * aux0[64 + i]; s23 += aux0[128 + i] * aux0[192 + i]; } lam = expf(s01) - expf(s23) + 0.2f; }
    const int NMAP = (MODE == 0) ? 2 : 1;
    for (int mp = 0; mp < NMAP; ++mp) {
        float q[16];
        { const float* qp = proj + (rowb + t) * ld + qcol + mp * 64 + p * 16;
#pragma unroll
          for (int i = 0; i < 16; i += 4) { const float4 v = *(const float4*)(qp + i); q[i] = v.x * ASCALE; q[i + 1] = v.y * ASCALE; q[i + 2] = v.z * ASCALE; q[i + 3] = v.w * ASCALE; } }
        unsigned selmask = 0u; const int own = qt >> 2;
        if (MODE == 1) {
            float g[8];
#pragma unroll
            for (int n = 0; n < 8; ++n) { const float* km = aux0 + (((size_t)b * 8 + h) * 8 + n) * 64 + p * 16; float s = 0.f;
#pragma unroll
                for (int i = 0; i < 16; ++i) s += q[i] * km[i];
                g[n] = red4(s); }
#pragma unroll
            for (int n = 0; n < 8; ++n) { int rank = 0;
#pragma unroll
                for (int n2 = 0; n2 < 8; ++n2) if (n2 != n && n2 < own && (g[n2] > g[n] || (g[n2] == g[n] && n2 < n))) ++rank;
                if (n < own && rank < 3) selmask |= 1u << n; }
        }
        float cq = 0.f; const float* cum = nullptr;
        if (MODE == 2) { cum = aux0 + ((size_t)b * 8 + h) * SEQ; cq = cum[t]; }
        float m = -INFINITY, l = 0.f, o[DVP];
#pragma unroll
        for (int i = 0; i < DVP; ++i) o[i] = 0.f;
        for (int kt = 0; kt <= qt; ++kt) {
            __syncthreads();
            for (int i = tid; i < 64 * 16; i += 256) { const int kr = i >> 4, c4 = (i & 15) * 4; *(float4*)&Ks[kr][c4] = *(const float4*)(proj + (rowb + kt * 64 + kr) * ld + kcol + mp * 64 + c4); }
            for (int i = tid; i < 64 * (DV / 4); i += 256) { const int kr = i / (DV / 4), c4 = (i % (DV / 4)) * 4; *(float4*)&Vs[kr][c4] = *(const float4*)(proj + (rowb + kt * 64 + kr) * ld + vcol + c4); }
            __syncthreads();
            bool tile_on = true;
            if (MODE == 1) { const int blk = kt >> 2; tile_on = (blk == own) || ((selmask >> blk) & 1u); }
            for (int j = 0; j < 64; ++j) {
                const int key = kt * 64 + j;
                float s = 0.f;
#pragma unroll
                for (int i = 0; i < 16; ++i) s += q[i] * Ks[j][p * 16 + i];
                s = red4(s);
                const bool ok = tile_on && key <= t;
                if (ok) {
                    const int d = t - key;
                    if (MODE == 2) s += cq - cum[key]; else s += biasd[d < 127 ? d : 127];
                    osm_update<DVP>(s, &Vs[j][p * DVP], m, l, o);
                }
            }
        }
        const float inv = 1.f / l;
        if (MODE == 0) {
            if (mp == 0) {
#pragma unroll
                for (int i = 0; i < DVP; ++i) res[i] = o[i] * inv;
            } else {
#pragma unroll
                for (int i = 0; i < DVP; ++i) res[i] -= lam * (o[i] * inv);
            }
        } else {
#pragma unroll
            for (int i = 0; i < DVP; ++i) res[i] = o[i] * inv;
        }
    }
    if (MODE == 0) {
        float ss = 0.f;
#pragma unroll
        for (int i = 0; i < DVP; ++i) ss += res[i] * res[i];
        ss = red4(ss);
        const float rs = rsqrtf(ss * (1.f / 128.f) + LN_EPS) * 0.8f;
#pragma unroll
        for (int i = 0; i < DVP; ++i) res[i] = res[i] * rs * aux1[p * DVP + i];
    }
    float* op = out + (rowb + t) * DM + ocol + p * DVP;
#pragma unroll
    for (int i = 0; i < DVP; i += 4) *(float4*)(op + i) = make_float4(res[i], res[i + 1], res[i + 2], res[i + 3]);
}

__global__ void __launch_bounds__(256) attn_dilated_kernel(const float* __restrict__ proj, int ld, const float* __restrict__ rel_bias, float* __restrict__ out) {
    __shared__ float biasd[128];
    const int qt = blockIdx.x, h = blockIdx.y, b = blockIdx.z;
    const int tid = threadIdx.x, r = tid >> 2, p = tid & 3;
    const int t = qt * 64 + r;
    const size_t rowb = (size_t)b * SEQ;
    if (tid < 128) biasd[tid] = rel_bias[t5_bucket(tid) * 12 + 4 + h];
    __syncthreads();
    const int qcol = 1536 + h * 64, kcol = 2048 + h * 64, vcol = 2560 + h * 64, ocol = 512 + h * 64;
    float q[16];
    { const float* qp = proj + (rowb + t) * ld + qcol + p * 16;
#pragma unroll
      for (int i = 0; i < 16; i += 4) { const float4 v = *(const float4*)(qp + i); q[i] = v.x * ASCALE; q[i + 1] = v.y * ASCALE; q[i + 2] = v.z * ASCALE; q[i + 3] = v.w * ASCALE; } }
    float op_[3][16], lse[3];
    const int dils[3] = {1, 4, 16};
#pragma unroll
    for (int pt = 0; pt < 3; ++pt) {
        const int dil = dils[pt], rr = t % dil, u = t / dil;
        float m = -INFINITY, l = 0.f, o[16];
#pragma unroll
        for (int i = 0; i < 16; ++i) o[i] = 0.f;
        for (int j = 0; j <= 128; ++j) {
            const int uk = u - j; const bool ok = uk >= 0;
            const int pos = ok ? uk * dil + rr : t;
            const float* kp = proj + (rowb + pos) * ld + kcol + p * 16;
            const float* vp = proj + (rowb + pos) * ld + vcol + p * 16;
            float s = 0.f; float vv[16];
#pragma unroll
            for (int i = 0; i < 16; i += 4) { const float4 kv = *(const float4*)(kp + i); s += q[i] * kv.x + q[i + 1] * kv.y + q[i + 2] * kv.z + q[i + 3] * kv.w;
                const float4 v4 = *(const float4*)(vp + i); vv[i] = v4.x; vv[i + 1] = v4.y; vv[i + 2] = v4.z; vv[i + 3] = v4.w; }
            s = red4(s);
            if (ok) { const int d = j * dil; s += biasd[d < 127 ? d : 127]; osm_update<16>(s, vv, m, l, o); }
        }
        lse[pt] = m + logf(l);
        const float inv = 1.f / l;
#pragma unroll
        for (int i = 0; i < 16; ++i) op_[pt][i] = o[i] * inv;
    }
    const float mx = fmaxf(lse[0], fmaxf(lse[1], lse[2]));
    const float w0 = expf(lse[0] - mx), w1 = expf(lse[1] - mx), w2 = expf(lse[2] - mx), ws = 1.f / (w0 + w1 + w2);
    float* op = out + (rowb + t) * DM + ocol + p * 16;
#pragma unroll
    for (int i = 0; i < 16; i += 4) {
        float4 v; v.x = (w0 * op_[0][i] + w1 * op_[1][i] + w2 * op_[2][i]) * ws; v.y = (w0 * op_[0][i + 1] + w1 * op_[1][i + 1] + w2 * op_[2][i + 1]) * ws;
        v.z = (w0 * op_[0][i + 2] + w1 * op_[1][i + 2] + w2 * op_[2][i + 2]) * ws; v.w = (w0 * op_[0][i + 3] + w1 * op_[1][i + 3] + w2 * op_[2][i + 3]) * ws;
        *(float4*)(op + i) = v;
    }
}

__global__ void __launch_bounds__(64) kmean_kernel(const float* __restrict__ proj, int ld, float* __restrict__ kmean) {
    const int blk = blockIdx.x, h = blockIdx.y, b = blockIdx.z, d = threadIdx.x;
    float s = 0.f;
    for (int i = 0; i < 256; ++i) s += proj[((size_t)b * SEQ + blk * 256 + i) * ld + 512 + h * 64 + d];
    kmean[(((size_t)b * 8 + h) * 8 + blk) * 64 + d] = s * (1.f / 256.f);
}
__global__ void __launch_bounds__(256) cum_kernel(const float* __restrict__ proj, int ld, const float* __restrict__ forget_b, float* __restrict__ cum) {
    __shared__ float part[256];
    const int h = blockIdx.x, b = blockIdx.y, tid = threadIdx.x;
    const float fb = forget_b[h];
    float v[8], s = 0.f;
#pragma unroll
    for (int i = 0; i < 8; ++i) { const float xx = proj[((size_t)b * SEQ + tid * 8 + i) * ld + 3072 + h] + fb; const float lf = fminf(xx, 0.f) - log1pf(expf(-fabsf(xx))); s += lf; v[i] = s; }
    part[tid] = s; __syncthreads();
    for (int off = 1; off < 256; off <<= 1) { float add = (tid >= off) ? part[tid - off] : 0.f; __syncthreads(); part[tid] += add; __syncthreads(); }
    const float base = (tid > 0) ? part[tid - 1] : 0.f;
#pragma unroll
    for (int i = 0; i < 8; ++i) cum[((size_t)b * 8 + h) * SEQ + tid * 8 + i] = base + v[i];
}

__global__ void __launch_bounds__(256) postln_kernel(const float* __restrict__ x, const float* __restrict__ y, const float* __restrict__ ada_l, int off_g,
                                                     const float* __restrict__ lg, const float* __restrict__ lb, float* __restrict__ out, int row0) {
    const int lane = threadIdx.x & 63, w = threadIdx.x >> 6;
    const int lrow = blockIdx.x * 4 + w, row = row0 + lrow, b = row / SEQ;
    float v[16]; float s = 0.f;
#pragma unroll
    for (int j = 0; j < 4; ++j) {
        const int c = j * 256 + lane * 4;
        const float4 xv = *(const float4*)(x + (size_t)row * DM + c), yv = *(const float4*)(y + (size_t)lrow * DM + c), gv = *(const float4*)(ada_l + (size_t)b * 6 * DM + off_g + c);
        v[j * 4 + 0] = ALPHA * xv.x + (1.f + gv.x) * yv.x; v[j * 4 + 1] = ALPHA * xv.y + (1.f + gv.y) * yv.y; v[j * 4 + 2] = ALPHA * xv.z + (1.f + gv.z) * yv.z; v[j * 4 + 3] = ALPHA * xv.w + (1.f + gv.w) * yv.w;
        s += v[j * 4] + v[j * 4 + 1] + v[j * 4 + 2] + v[j * 4 + 3];
    }
#pragma unroll
    for (int o = 1; o < 64; o <<= 1) s += __shfl_xor(s, o);
    const float mean = s * (1.f / DM); float q = 0.f;
#pragma unroll
    for (int i = 0; i < 16; ++i) { v[i] -= mean; q += v[i] * v[i]; }
#pragma unroll
    for (int o = 1; o < 64; o <<= 1) q += __shfl_xor(q, o);
    const float rstd = rsqrtf(q * (1.f / DM) + LN_EPS);
#pragma unroll
    for (int j = 0; j < 4; ++j) {
        const int c = j * 256 + lane * 4;
        const float4 g4 = *(const float4*)(lg + c), b4 = *(const float4*)(lb + c);
        *(float4*)(out + (size_t)row * DM + c) = make_float4(v[j * 4] * rstd * g4.x + b4.x, v[j * 4 + 1] * rstd * g4.y + b4.y, v[j * 4 + 2] * rstd * g4.z + b4.z, v[j * 4 + 3] * rstd * g4.w + b4.w);
    }
}
__global__ void __launch_bounds__(256) swiglu_kernel(const float* __restrict__ ff, float* __restrict__ ffh) {
    const size_t i = (size_t)blockIdx.x * 256 + threadIdx.x;
    const int row = (int)(i / (DFF / 4)), c4 = (int)(i % (DFF / 4));
    const float4 g = *(const float4*)(ff + (size_t)row * 2 * DFF + c4 * 4), u = *(const float4*)(ff + (size_t)row * 2 * DFF + DFF + c4 * 4);
    float4 o; o.x = g.x / (1.f + expf(-g.x)) * u.x; o.y = g.y / (1.f + expf(-g.y)) * u.y; o.z = g.z / (1.f + expf(-g.z)) * u.z; o.w = g.w / (1.f + expf(-g.w)) * u.w;
    ((float4*)ffh)[i] = o;
}

extern "C" void kernel_launch(void* const* d_in, const int* in_sizes, int n_in, void* d_out, int out_size, void* d_ws, size_t ws_size, hipStream_t stream) {
    const float* x = (const float*)d_in[0]; const float* c = (const float*)d_in[1]; const float* rel_bias = (const float*)d_in[2];
    const float* w_ada = (const float*)d_in[3]; const float* b_ada = (const float*)d_in[4]; const float* ln_g = (const float*)d_in[5]; const float* ln_b = (const float*)d_in[6];
    const float* w_in_ab = (const float*)d_in[7]; const float* diff_lambda = (const float*)d_in[8]; const float* diff_subln_g = (const float*)d_in[9];
    const float* w_in_cd = (const float*)d_in[10]; const float* forget_b = (const float*)d_in[11]; const float* w_o = (const float*)d_in[12];
    const float* w_ffn_in = (const float*)d_in[13]; const float* w_ffn_out = (const float*)d_in[14];
    float* out = (float*)d_out;
    char* ws = (char*)d_ws; size_t off = 0;
    auto carve = [&](size_t bytes) { char* p = ws + off; off += (bytes + 255) & ~(size_t)255; return (float*)p; };
    float* ada = carve((size_t)2 * 16 * 6 * DM * 4);
    float* XA = carve((size_t)MTOK * DM * 4);
    float* R1 = carve((size_t)CH_T * 2 * DFF * 4);
    float* R2 = carve((size_t)CH_T * DFF * 4);
    float* Y = carve((size_t)CH_T * DM * 4);
    float* KM = carve((size_t)CH_B * 8 * 8 * 64 * 4);
    float* CUM = carve((size_t)CH_B * 8 * SEQ * 4);
    if (off > ws_size) { fprintf(stderr, "workspace too small: need %zu have %zu\n", off, ws_size); return; }
    float* PROJ = R1; float* ATT = R1 + (size_t)CH_T * IN_CD; float* FF = R1; float* H = R2; float* FFH = R2;

    ada_kernel<<<dim3(6 * DM / 256, 2), 256, 0, stream>>>(c, w_ada, b_ada, ada);
    for (int l = 0; l < 2; ++l) {
        const float* ada_l = ada + (size_t)l * 16 * 6 * DM;
        const float* xin = (l == 0) ? x : out;
        float* xfin = out;
        const int ldp = (l == 0) ? IN_AB : IN_CD;
        const float* w_in = (l == 0) ? w_in_ab : w_in_cd;
        for (int ch = 0; ch < NCH; ++ch) {
            const int row0 = ch * CH_T;
            mod_kernel<<<CH_T * DM / 4 / 256, 256, 0, stream>>>(xin, ada_l, 0, DM, H, row0);
            gemm_f32<<<dim3((ldp + 63) / 64, CH_T / 64), 256, 0, stream>>>(H, DM, w_in, ldp, PROJ, ldp, CH_T, ldp, DM);
            if (l == 0) {
                attn_dense_kernel<0, 128><<<dim3(SEQ / 64, 4, CH_B), 256, 0, stream>>>(PROJ, ldp, rel_bias, diff_lambda, diff_subln_g, ATT);
                attn_dilated_kernel<<<dim3(SEQ / 64, 8, CH_B), 256, 0, stream>>>(PROJ, ldp, rel_bias, ATT);
            } else {
                kmean_kernel<<<dim3(8, 8, CH_B), 64, 0, stream>>>(PROJ, ldp, KM);
                cum_kernel<<<dim3(8, CH_B), 256, 0, stream>>>(PROJ, ldp, forget_b, CUM);
                attn_dense_kernel<1, 64><<<dim3(SEQ / 64, 8, CH_B), 256, 0, stream>>>(PROJ, ldp, rel_bias, KM, nullptr, ATT);
                attn_dense_kernel<2, 64><<<dim3(SEQ / 64, 8, CH_B), 256, 0, stream>>>(PROJ, ldp, rel_bias, CUM, nullptr, ATT);
            }
            gemm_f32<<<dim3(DM / 64, CH_T / 64), 256, 0, stream>>>(ATT, DM, w_o + (size_t)l * DM * DM, DM, Y, DM, CH_T, DM, DM);
            postln_kernel<<<CH_T / 4, 256, 0, stream>>>(xin, Y, ada_l, 2 * DM, ln_g + (size_t)(l * 2 + 0) * DM, ln_b + (size_t)(l * 2 + 0) * DM, XA, row0);
        }
        for (int ch = 0; ch < NCH; ++ch) {
            const int row0 = ch * CH_T;
            mod_kernel<<<CH_T * DM / 4 / 256, 256, 0, stream>>>(XA, ada_l, 3 * DM, 4 * DM, H, row0);
            gemm_f32<<<dim3(2 * DFF / 64, CH_T / 64), 256, 0, stream>>>(H, DM, w_ffn_in + (size_t)l * DM * 2 * DFF, 2 * DFF, FF, 2 * DFF, CH_T, 2 * DFF, DM);
            swiglu_kernel<<<CH_T * (DFF / 4) / 256, 256, 0, stream>>>(FF, FFH);
            gemm_f32<<<dim3(DM / 64, CH_T / 64), 256, 0, stream>>>(FFH, DFF, w_ffn_out + (size_t)l * DFF * DM, DM, Y, DM, CH_T, DM, DFF);
            postln_kernel<<<CH_T / 4, 256, 0, stream>>>(XA, Y, ada_l, 5 * DM, ln_g + (size_t)(l * 2 + 1) * DM, ln_b + (size_t)(l * 2 + 1) * DM, xfin, row0);
        }
    }
}
```
